# Optimizing an MI355X kernel written in HIP

```python
import math
import jax, jax.numpy as jnp
from jax import lax
import numpy as np

D_MODEL = 2048
BATCH = 4
SEQ = 2048
DEPTH = 1

MEM_LEN = 256
HEAD_DIM = 64
CONV_DIM = 3 * D_MODEL // 8
CONV_WIDTH = 3
SWA_HEADS = 3 * D_MODEL // (8 * HEAD_DIM)
SWA_KV_HEADS = 4
SWA_GROUP = SWA_HEADS // SWA_KV_HEADS
SWA_DIM = SWA_HEADS * HEAD_DIM
KV_DIM = SWA_KV_HEADS * HEAD_DIM
WINDOW = 128
BLOCK = 128
MEM_HEADS = 4
MEM_DIM = D_MODEL // 4
MEM_HEAD_DIM = MEM_DIM // MEM_HEADS
MIX_DIM = CONV_DIM + SWA_DIM + MEM_DIM
PROJ_DIM = 3 * CONV_DIM + SWA_DIM + 2 * KV_DIM + MEM_DIM
D_FF = 256 * (-(-(8 * D_MODEL // 3) // 256))
N_BUCKETS = 32
MAX_DISTANCE = 128
ALPHA = (2.0 * DEPTH) ** 0.25
BETA = (8.0 * DEPTH) ** -0.25
LN_EPS = 1e-5
NEG_INF = -1e30

kernel_name = "hymba_conv_swa_mem_macaron_deepnorm"


def _layer_norm(x, g, b):
    xf = x.astype(jnp.float32)
    mu = xf.mean(-1, keepdims=True)
    var = jnp.square(xf - mu).mean(-1, keepdims=True)
    return ((xf - mu) * lax.rsqrt(var + LN_EPS) * g + b).astype(x.dtype)


def _swiglu(x, w_gate, w_up, w_down):
    return (jax.nn.silu(x @ w_gate) * (x @ w_up)) @ w_down


def _short_conv(u, w):
    s = u.shape[1]
    up = jnp.pad(u, ((0, 0), (CONV_WIDTH - 1, 0), (0, 0)))
    y = w[CONV_WIDTH - 1] * u
    for j in range(CONV_WIDTH - 1):
        y = y + w[j] * up[:, j:j + s]
    return y


def _t5_bucket(dist):
    max_exact = N_BUCKETS // 2
    d = jnp.maximum(dist, 1).astype(jnp.float32)
    large = max_exact + (jnp.log(d / max_exact) / math.log(MAX_DISTANCE / max_exact)
                         * (N_BUCKETS - max_exact)).astype(jnp.int32)
    large = jnp.minimum(large, N_BUCKETS - 1)
    return jnp.where(dist < max_exact, dist, large)


def _sliding_window_attention(q, k, v, rel_bias, sinks):
    b, s = q.shape[:2]
    nb = s // BLOCK
    qb = q.reshape(b, nb, BLOCK, SWA_KV_HEADS, SWA_GROUP, HEAD_DIM)

    def band(t):
        tb = t.reshape(b, nb, BLOCK, SWA_KV_HEADS, HEAD_DIM)
        prev = jnp.pad(tb, ((0, 0), (1, 0), (0, 0), (0, 0), (0, 0)))[:, :-1]
        return jnp.concatenate([prev, tb], axis=2)

    kb, vb = band(k), band(v)
    logits = jnp.einsum('bnqhgd,bnkhd->bnhgqk', qb, kb).astype(jnp.float32) * (HEAD_DIM ** -0.5)

    qi = jnp.arange(BLOCK)[:, None]
    kj = jnp.arange(2 * BLOCK)[None, :]
    dist = qi + BLOCK - kj
    in_window = (dist >= 0) & (dist < WINDOW)
    key_valid = (jnp.arange(nb)[:, None] * BLOCK - BLOCK + kj) >= 0
    mask = in_window[None] & key_valid[:, None, :]

    bias = rel_bias[_t5_bucket(jnp.maximum(dist, 0))]
    bias = bias.transpose(2, 0, 1).reshape(SWA_KV_HEADS, SWA_GROUP, BLOCK, 2 * BLOCK)
    logits = jnp.where(mask[None, :, None, None], logits + bias.astype(jnp.float32), NEG_INF)

    sink = sinks.astype(jnp.float32).reshape(1, 1, SWA_KV_HEADS, SWA_GROUP, 1, 1)
    m = jnp.maximum(logits.max(-1, keepdims=True), sink)
    p = jnp.exp(logits - m)
    probs = p / (p.sum(-1, keepdims=True) + jnp.exp(sink - m))
    out = jnp.einsum('bnhgqk,bnkhd->bnqhgd', probs.astype(vb.dtype), vb)
    return out.reshape(b, s, SWA_DIM)


def _memory_attention(qm, mem_k, mem_v):
    b, s = qm.shape[:2]
    q = qm.reshape(b, s, MEM_HEADS, MEM_HEAD_DIM)
    k = mem_k.reshape(b, MEM_LEN, MEM_HEADS, MEM_HEAD_DIM)
    v = mem_v.reshape(b, MEM_LEN, MEM_HEADS, MEM_HEAD_DIM)
    logits = jnp.einsum('bshd,bmhd->bhsm', q, k).astype(jnp.float32) * (MEM_HEAD_DIM ** -0.5)
    p = jax.nn.softmax(logits, axis=-1)
    return jnp.einsum('bhsm,bmhd->bshd', p.astype(v.dtype), v).reshape(b, s, MEM_DIM)


def setup_inputs(seed: int = 0) -> dict:
    key = jax.random.key(seed)
    ks = jax.random.split(key, 24)
    f32 = jnp.float32
    nrm = lambda k, shape, scale: jax.random.normal(k, shape, f32) * scale
    L = DEPTH
    col_scale = jnp.concatenate([
        jnp.ones((2 * CONV_DIM,), f32), jnp.full((CONV_DIM,), BETA, f32),
        jnp.ones((SWA_DIM + KV_DIM,), f32), jnp.full((KV_DIM,), BETA, f32),
        jnp.ones((MEM_DIM,), f32)])
    mem_scale = jnp.concatenate([jnp.ones((MEM_DIM,), f32), jnp.full((MEM_DIM,), BETA, f32)])
    return {
        "x": nrm(ks[0], (BATCH, SEQ, D_MODEL), 1.0),
        "mem": nrm(ks[1], (BATCH, MEM_LEN, D_MODEL), 1.0),
        "ln1_g": 1.0 + nrm(ks[2], (L, D_MODEL), 0.01),
        "ln1_b": nrm(ks[3], (L, D_MODEL), 0.01),
        "ffn1_w_gate": nrm(ks[4], (L, D_MODEL, D_FF), BETA * D_MODEL ** -0.5),
        "ffn1_w_up": nrm(ks[5], (L, D_MODEL, D_FF), BETA * D_MODEL ** -0.5),
        "ffn1_w_down": nrm(ks[6], (L, D_FF, D_MODEL), BETA * D_FF ** -0.5),
        "w_in": nrm(ks[7], (L, D_MODEL, PROJ_DIM), D_MODEL ** -0.5) * col_scale,
        "b_in": nrm(ks[8], (L, PROJ_DIM), 0.01),
        "conv_w": nrm(ks[9], (L, CONV_WIDTH, CONV_DIM), CONV_WIDTH ** -0.5),
        "sinks": nrm(ks[10], (L, SWA_HEADS), 0.5),
        "w_mem_kv": nrm(ks[11], (L, D_MODEL, 2 * MEM_DIM), D_MODEL ** -0.5) * mem_scale,
        "w_out": nrm(ks[12], (L, MIX_DIM, D_MODEL), BETA * MIX_DIM ** -0.5),
        "ln2_g": 1.0 + nrm(ks[13], (L, D_MODEL), 0.01),
        "ln2_b": nrm(ks[14], (L, D_MODEL), 0.01),
        "ffn2_w_gate": nrm(ks[15], (L, D_MODEL, D_FF), BETA * D_MODEL ** -0.5),
        "ffn2_w_up": nrm(ks[16], (L, D_MODEL, D_FF), BETA * D_MODEL ** -0.5),
        "ffn2_w_down": nrm(ks[17], (L, D_FF, D_MODEL), BETA * D_FF ** -0.5),
        "ln3_g": 1.0 + nrm(ks[18], (L, D_MODEL), 0.01),
        "ln3_b": nrm(ks[19], (L, D_MODEL), 0.01),
        "rel_bias": nrm(ks[20], (N_BUCKETS, SWA_HEADS), 0.2),
    }


def reference(x, mem, ln1_g, ln1_b, ffn1_w_gate, ffn1_w_up, ffn1_w_down, w_in, b_in,
              conv_w, sinks, w_mem_kv, w_out, ln2_g, ln2_b, ffn2_w_gate, ffn2_w_up,
              ffn2_w_down, ln3_g, ln3_b, rel_bias):
    splits = list(np.cumsum([CONV_DIM, CONV_DIM, CONV_DIM, SWA_DIM, KV_DIM, KV_DIM]))
    h = x
    for l in range(DEPTH):
        h = _layer_norm(ALPHA * h + 0.5 * _swiglu(h, ffn1_w_gate[l], ffn1_w_up[l], ffn1_w_down[l]),
                        ln1_g[l], ln1_b[l])
        proj = h @ w_in[l] + b_in[l]
        b_gate, c_gate, u, q, k, v, qm = jnp.split(proj, splits, axis=-1)
        conv_out = b_gate * _short_conv(c_gate * u, conv_w[l])
        swa_out = _sliding_window_attention(q, k, v, rel_bias, sinks[l])
        mem_k, mem_v = jnp.split(mem @ w_mem_kv[l], 2, axis=-1)
        mem_out = _memory_attention(qm, mem_k, mem_v)
        mix = jnp.concatenate([conv_out, swa_out, mem_out], axis=-1) @ w_out[l]
        h = _layer_norm(ALPHA * h + mix, ln2_g[l], ln2_b[l])
        h = _layer_norm(ALPHA * h + 0.5 * _swiglu(h, ffn2_w_gate[l], ffn2_w_up[l], ffn2_w_down[l]),
                        ln3_g[l], ln3_b[l])
    return h
```

```cpp
#include <hip/hip_runtime.h>
#include <cstdio>
#include <cstdint>

namespace {
constexpr int D = 2048, BATCH = 4, SEQ = 2048, M = BATCH * SEQ, MEM_LEN = 256, HD = 64;
constexpr int CONV = 768, SWAD = 768, KVD = 256, MEMD = 512, MIX = 2048, PROJ = 4096, FF = 5632;
constexpr int NH = 12, NKV = 4, GRP = 3, WIN = 128, MH = 4, MHD = 128;
constexpr float ALPHA = 1.189207115002721f;
constexpr float LN_EPS = 1e-5f;

__device__ const unsigned char T5B[128] = {0, 1, 2, 3, 4, 5, 6, 7, 8, 9, 10, 11, 12, 13, 14, 15, 16, 16, 16, 17, 17, 18, 18, 18, 19, 19, 19, 20, 20, 20, 20, 21, 21, 21, 21, 22, 22, 22, 22, 22, 23, 23, 23, 23, 23, 23, 24, 24, 24, 24, 24, 24, 25, 25, 25, 25, 25, 25, 25, 26, 26, 26, 26, 26, 26, 26, 26, 27, 27, 27, 27, 27, 27, 27, 27, 27, 27, 28, 28, 28, 28, 28, 28, 28, 28, 28, 28, 29, 29, 29, 29, 29, 29, 29, 29, 29, 29, 29, 29, 30, 30, 30, 30, 30, 30, 30, 30, 30, 30, 30, 30, 30, 30, 31, 31, 31, 31, 31, 31, 31, 31, 31, 31, 31, 31, 31, 31, 31};

template <bool SWIGLU>
__global__ void __launch_bounds__(256) k_gemm(const float* __restrict__ A, const float* __restrict__ B, const float* __restrict__ B2, float* __restrict__ C,
                                              int Mm, int N, int K, int lda, int ldb, int ldc, const float* __restrict__ R, int ldr, float rs, float s, const float* __restrict__ bias) {
    __shared__ float As[16][64 + 4];
    __shared__ float Bs[16][64 + 4];
    __shared__ float B2s[SWIGLU ? 16 : 1][64 + 4];
    const int tid = threadIdx.x, tx = tid & 15, ty = tid >> 4;
    const int m0 = blockIdx.y * 64, n0 = blockIdx.x * 64;
    float acc[4][4] = {}, acc2[4][4] = {};
    for (int k0 = 0; k0 < K; k0 += 16) {
        {
            const int r = tid >> 2, c = (tid & 3) * 4;
            const float4 v = *(const float4*)(A + (size_t)(m0 + r) * lda + k0 + c);
            As[c + 0][r] = v.x; As[c + 1][r] = v.y; As[c + 2][r] = v.z; As[c + 3][r] = v.w;
        }
        {
            const int r = tid >> 4, c = (tid & 15) * 4;
            const float4 v = *(const float4*)(B + (size_t)(k0 + r) * ldb + n0 + c);
            *(float4*)&Bs[r][c] = v;
            if (SWIGLU) { const float4 w = *(const float4*)(B2 + (size_t)(k0 + r) * ldb + n0 + c); *(float4*)&B2s[r][c] = w; }
        }
        __syncthreads();
#pragma unroll
        for (int kk = 0; kk < 16; ++kk) {
            const float4 a = *(const float4*)&As[kk][ty * 4];
            const float4 b = *(const float4*)&Bs[kk][tx * 4];
            const float av[4] = {a.x, a.y, a.z, a.w}, bv[4] = {b.x, b.y, b.z, b.w};
#pragma unroll
            for (int i = 0; i < 4; ++i)
#pragma unroll
                for (int j = 0; j < 4; ++j) acc[i][j] = fmaf(av[i], bv[j], acc[i][j]);
            if (SWIGLU) {
                const float4 b2 = *(const float4*)&B2s[kk][tx * 4];
                const float b2v[4] = {b2.x, b2.y, b2.z, b2.w};
#pragma unroll
                for (int i = 0; i < 4; ++i)
#pragma unroll
                    for (int j = 0; j < 4; ++j) acc2[i][j] = fmaf(av[i], b2v[j], acc2[i][j]);
            }
        }
        __syncthreads();
    }
#pragma unroll
    for (int i = 0; i < 4; ++i) {
        const int m = m0 + ty * 4 + i;
        float o[4];
#pragma unroll
        for (int j = 0; j < 4; ++j) {
            const int n = n0 + tx * 4 + j;
            float v;
            if (SWIGLU) { const float g = acc[i][j]; v = (g / (1.f + expf(-g))) * acc2[i][j]; }
            else { v = s * acc[i][j]; if (R) v += rs * R[(size_t)m * ldr + n]; if (bias) v += bias[n]; }
            o[j] = v;
        }
        *(float4*)(C + (size_t)m * ldc + n0 + tx * 4) = make_float4(o[0], o[1], o[2], o[3]);
    }
}

__global__ void __launch_bounds__(256) k_ln(const float* __restrict__ X, float* __restrict__ Y, const float* __restrict__ g, const float* __restrict__ b) {
    __shared__ float red[8];
    const int row = blockIdx.x, tid = threadIdx.x;
    const float* x = X + (size_t)row * D;
    float v[8]; float s = 0.f;
#pragma unroll
    for (int j = 0; j < 8; ++j) { v[j] = x[tid + 256 * j]; s += v[j]; }
    for (int o = 32; o > 0; o >>= 1) s += __shfl_xor(s, o);
    if ((tid & 63) == 0) red[tid >> 6] = s;
    __syncthreads();
    const float mean = (red[0] + red[1] + red[2] + red[3]) * (1.f / D);
    float q = 0.f;
#pragma unroll
    for (int j = 0; j < 8; ++j) { v[j] -= mean; q += v[j] * v[j]; }
    for (int o = 32; o > 0; o >>= 1) q += __shfl_xor(q, o);
    if ((tid & 63) == 0) red[4 + (tid >> 6)] = q;
    __syncthreads();
    const float var = (red[4] + red[5] + red[6] + red[7]) * (1.f / D);
    const float rstd = 1.f / sqrtf(var + LN_EPS);
#pragma unroll
    for (int j = 0; j < 8; ++j) { const int c = tid + 256 * j; Y[(size_t)row * D + c] = v[j] * rstd * g[c] + b[c]; }
}

__global__ void __launch_bounds__(256) k_conv(const float* __restrict__ proj, const float* __restrict__ cw, float* __restrict__ mix) {
    const int idx = blockIdx.x * 256 + threadIdx.x;
    if (idx >= M * CONV) return;
    const int m = idx / CONV, c = idx % CONV, t = m % SEQ;
    const float* p = proj + (size_t)m * PROJ;
    float y = cw[2 * CONV + c] * (p[CONV + c] * p[2 * CONV + c]);
    if (t >= 1) { const float* p1 = p - PROJ; y += cw[1 * CONV + c] * (p1[CONV + c] * p1[2 * CONV + c]); }
    if (t >= 2) { const float* p2 = p - 2 * PROJ; y += cw[0 * CONV + c] * (p2[CONV + c] * p2[2 * CONV + c]); }
    mix[(size_t)m * MIX + c] = p[c] * y;
}

__global__ void __launch_bounds__(128) k_swa(const float* __restrict__ proj, const float* __restrict__ rel_bias, const float* __restrict__ sinks, float* __restrict__ mix) {
    __shared__ float qs[64];
    __shared__ float ps[128];
    __shared__ float red[4];
    const int m = blockIdx.x, h = blockIdx.y, tid = threadIdx.x;
    const int t = m % SEQ, kvh = h / GRP;
    const float* qrow = proj + (size_t)m * PROJ + 3 * CONV + h * HD;
    if (tid < 64) qs[tid] = qrow[tid];
    __syncthreads();
    const int dist = 127 - tid;
    const bool valid = (t - dist) >= 0;
    float logit = -1e30f;
    if (valid) {
        const float* krow = proj + (size_t)(m - dist) * PROJ + 3 * CONV + SWAD + kvh * HD;
        float s = 0.f;
#pragma unroll 8
        for (int d = 0; d < 64; ++d) s = fmaf(qs[d], krow[d], s);
        logit = s * 0.125f + rel_bias[T5B[dist] * NH + h];
    }
    const float sink = sinks[h];
    float mx = logit;
    for (int o = 32; o > 0; o >>= 1) mx = fmaxf(mx, __shfl_xor(mx, o));
    if ((tid & 63) == 0) red[tid >> 6] = mx;
    __syncthreads();
    mx = fmaxf(fmaxf(red[0], red[1]), sink);
    const float p = valid ? expf(logit - mx) : 0.f;
    ps[tid] = p;
    float sm = p;
    for (int o = 32; o > 0; o >>= 1) sm += __shfl_xor(sm, o);
    if ((tid & 63) == 0) red[2 + (tid >> 6)] = sm;
    __syncthreads();
    const float denom = red[2] + red[3] + expf(sink - mx);
    if (tid < 64) {
        float o = 0.f;
        for (int j = 0; j < 128; ++j) {
            const int dj = 127 - j;
            if (t - dj >= 0) o = fmaf(ps[j], proj[(size_t)(m - dj) * PROJ + 3 * CONV + SWAD + KVD + kvh * HD + tid], o);
        }
        mix[(size_t)m * MIX + CONV + h * HD + tid] = o / denom;
    }
}

__global__ void __launch_bounds__(256) k_mem(const float* __restrict__ proj, const float* __restrict__ memkv, float* __restrict__ mix) {
    __shared__ float qs[128];
    __shared__ float ps[256];
    __shared__ float red[8];
    const int m = blockIdx.x, h = blockIdx.y, tid = threadIdx.x;
    const int b = m / SEQ;
    if (tid < 128) qs[tid] = proj[(size_t)m * PROJ + 3 * CONV + SWAD + 2 * KVD + h * MHD + tid];
    __syncthreads();
    const float* krow = memkv + (size_t)(b * MEM_LEN + tid) * (2 * MEMD) + h * MHD;
    float s = 0.f;
#pragma unroll 8
    for (int d = 0; d < 128; ++d) s = fmaf(qs[d], krow[d], s);
    const float logit = s * 0.08838834764831845f;
    float mx = logit;
    for (int o = 32; o > 0; o >>= 1) mx = fmaxf(mx, __shfl_xor(mx, o));
    if ((tid & 63) == 0) red[tid >> 6] = mx;
    __syncthreads();
    mx = fmaxf(fmaxf(red[0], red[1]), fmaxf(red[2], red[3]));
    const float p = expf(logit - mx);
    ps[tid] = p;
    float sm = p;
    for (int o = 32; o > 0; o >>= 1) sm += __shfl_xor(sm, o);
    if ((tid & 63) == 0) red[4 + (tid >> 6)] = sm;
    __syncthreads();
    const float denom = red[4] + red[5] + red[6] + red[7];
    if (tid < 128) {
        float o = 0.f;
        for (int j = 0; j < 256; ++j) o = fmaf(ps[j], memkv[(size_t)(b * MEM_LEN + j) * (2 * MEMD) + MEMD + h * MHD + tid], o);
        mix[(size_t)m * MIX + CONV + SWAD + h * MHD + tid] = o / denom;
    }
}
}

extern "C" void kernel_launch(void* const* d_in, const int* in_sizes, int n_in, void* d_out, int out_size, void* d_ws, size_t ws_size, hipStream_t stream) {
    const float* x = (const float*)d_in[0];      const float* mem = (const float*)d_in[1];
    const float* ln1_g = (const float*)d_in[2];  const float* ln1_b = (const float*)d_in[3];
    const float* w1g = (const float*)d_in[4];    const float* w1u = (const float*)d_in[5];   const float* w1d = (const float*)d_in[6];
    const float* w_in = (const float*)d_in[7];   const float* b_in = (const float*)d_in[8];
    const float* conv_w = (const float*)d_in[9]; const float* sinks = (const float*)d_in[10];
    const float* w_mem = (const float*)d_in[11]; const float* w_out = (const float*)d_in[12];
    const float* ln2_g = (const float*)d_in[13]; const float* ln2_b = (const float*)d_in[14];
    const float* w2g = (const float*)d_in[15];   const float* w2u = (const float*)d_in[16];  const float* w2d = (const float*)d_in[17];
    const float* ln3_g = (const float*)d_in[18]; const float* ln3_b = (const float*)d_in[19];
    const float* rel_bias = (const float*)d_in[20];
    float* out = (float*)d_out;
    const size_t MiB = 1u << 20;
    if (ws_size < 340 * MiB) { fprintf(stderr, "ws too small: %zu\n", ws_size); return; }
    char* ws = (char*)d_ws;
    float* act = (float*)(ws);
    float* proj = (float*)(ws);
    float* mix = (float*)(ws + 128 * MiB);
    float* bufA = (float*)(ws + 192 * MiB);
    float* memkv = (float*)(ws + 256 * MiB);
    float* bufB = (float*)(ws + 264 * MiB);

    k_gemm<true><<<dim3(FF / 64, M / 64), 256, 0, stream>>>(x, w1g, w1u, act, M, FF, D, D, FF, FF, nullptr, 0, 0.f, 1.f, nullptr);
    k_gemm<false><<<dim3(D / 64, M / 64), 256, 0, stream>>>(act, w1d, nullptr, bufA, M, D, FF, FF, D, D, x, D, ALPHA, 0.5f, nullptr);
    k_ln<<<M, 256, 0, stream>>>(bufA, bufA, ln1_g, ln1_b);
    k_gemm<false><<<dim3(PROJ / 64, M / 64), 256, 0, stream>>>(bufA, w_in, nullptr, proj, M, PROJ, D, D, PROJ, PROJ, nullptr, 0, 0.f, 1.f, b_in);
    k_gemm<false><<<dim3(1024 / 64, (BATCH * MEM_LEN) / 64), 256, 0, stream>>>(mem, w_mem, nullptr, memkv, BATCH * MEM_LEN, 1024, D, D, 1024, 1024, nullptr, 0, 0.f, 1.f, nullptr);
    k_conv<<<(M * CONV + 255) / 256, 256, 0, stream>>>(proj, conv_w, mix);
    k_swa<<<dim3(M, NH), 128, 0, stream>>>(proj, rel_bias, sinks, mix);
    k_mem<<<dim3(M, MH), 256, 0, stream>>>(proj, memkv, mix);
    k_gemm<false><<<dim3(D / 64, M / 64), 256, 0, stream>>>(mix, w_out, nullptr, bufB, M, D, MIX, MIX, D, D, bufA, D, ALPHA, 1.f, nullptr);
    k_ln<<<M, 256, 0, stream>>>(bufB, bufB, ln2_g, ln2_b);
    k_gemm<true><<<dim3(FF / 64, M / 64), 256, 0, stream>>>(bufB, w2g, w2u, act, M, FF, D, D, FF, FF, nullptr, 0, 0.f, 1.f, nullptr);
    k_gemm<false><<<dim3(D / 64, M / 64), 256, 0, stream>>>(act, w2d, nullptr, bufA, M, D, FF, FF, D, D, bufB, D, ALPHA, 0.5f, nullptr);
    k_ln<<<M, 256, 0, stream>>>(bufA, out, ln3_g, ln3_b);
}
```

```cpp
#include <hip/hip_runtime.h>
#include <cstdio>
#include <cstdint>

#ifndef MK_PER_PHASE
#define MK_PER_PHASE 0
#endif

#define LAS __attribute__((address_space(3)))
#define GAS __attribute__((address_space(1)))
typedef unsigned short bf16_t;
typedef short bf16x8 __attribute__((ext_vector_type(8)));
typedef short s16x4 __attribute__((ext_vector_type(4)));
typedef float f32x4 __attribute__((ext_vector_type(4)));
typedef float f32x2 __attribute__((ext_vector_type(2)));
typedef unsigned u32x4 __attribute__((ext_vector_type(4)));
typedef unsigned u32x2 __attribute__((ext_vector_type(2)));
typedef __bf16 bf16x2_t __attribute__((ext_vector_type(2)));

constexpr int D = 2048, BATCH = 4, SEQ = 2048, M = BATCH * SEQ, MEM_LEN = 256, MEMROWS = BATCH * MEM_LEN;
constexpr int CONV = 768, SWAD = 768, KVD = 256, MEMD = 512, MIX = 2048, PROJ = 4096, FF = 5632, GU = 2 * FF;
constexpr int OFF_B = 0, OFF_C = 768, OFF_U = 1536, OFF_Q = 2304, OFF_K = 3072, OFF_V = 3328, OFF_QM = 3584;
constexpr int NH = 12;
constexpr float ALPHA = 1.189207115002721f;
constexpr float LN_EPS = 1e-5f;
constexpr int NWAVES = 8, NTHREADS = 512;

constexpr size_t MiB = 1u << 20;
constexpr size_t WS_CTL = 0, CTL_ZERO_BYTES = 64 * 1024;
constexpr size_t WS_W1GU = 2 * MiB, WS_W1D = 46 * MiB, WS_WIN = 68 * MiB, WS_WMEM = 84 * MiB, WS_WOUT = 88 * MiB, WS_W2GU = 96 * MiB, WS_W2D = 140 * MiB;
constexpr size_t WS_MEMB = 162 * MiB, WS_MEMKV = 166 * MiB, WS_AB = 168 * MiB, WS_R1 = 200 * MiB, WS_MIXB = 264 * MiB, WS_BUFA = 296 * MiB, WS_END = 360 * MiB;
constexpr int CW_BAR = 1024;

constexpr int SCR_BYTES = 143360;
constexpr int MISC_OFF = SCR_BYTES;
constexpr int LDS_BYTES = 147456;

__device__ const unsigned char T5B[128] = {0, 1, 2, 3, 4, 5, 6, 7, 8, 9, 10, 11, 12, 13, 14, 15, 16, 16, 16, 17, 17, 18, 18, 18, 19, 19, 19, 20, 20, 20, 20, 21, 21, 21, 21, 22, 22, 22, 22, 22, 23, 23, 23, 23, 23, 23, 24, 24, 24, 24, 24, 24, 25, 25, 25, 25, 25, 25, 25, 26, 26, 26, 26, 26, 26, 26, 26, 27, 27, 27, 27, 27, 27, 27, 27, 27, 27, 28, 28, 28, 28, 28, 28, 28, 28, 28, 28, 29, 29, 29, 29, 29, 29, 29, 29, 29, 29, 29, 29, 30, 30, 30, 30, 30, 30, 30, 30, 30, 30, 30, 30, 30, 30, 31, 31, 31, 31, 31, 31, 31, 31, 31, 31, 31, 31, 31, 31, 31};

__device__ __forceinline__ unsigned pk2(float lo, float hi) { f32x2 v = {lo, hi}; bf16x2_t b = __builtin_convertvector(v, bf16x2_t); return __builtin_bit_cast(unsigned, b); }

namespace pg8 {
constexpr int BM = 256, BK = 64, HALF = 128, HTB = HALF * BK * 2, STAGE_BYTES = 8 * HTB, NXCD = 8, WGM = 8;
__host__ __device__ __forceinline__ int lds_byte(int r, int c) { const int st = (r >> 4) * 2 + (c >> 5), rr = r & 15, cc = c & 31, ob = rr * 64 + cc * 2; return st * 1024 + (ob ^ (((ob >> 9) & 1) << 5)); }
__host__ __device__ __forceinline__ void stage_rc(int b, int& R, int& C) { const int st = b / 1024, sb = b % 1024, swz = sb ^ (((sb >> 9) & 1) << 5); R = (st >> 1) * 16 + swz / 64; C = (st & 1) * 32 + (swz % 64) / 2; }
__host__ __device__ __forceinline__ int perm32(int rho) { const int n = rho >> 4, i = rho & 15; return 8 * (i >> 2) + 4 * n + (i & 3); }

struct Unit { int pm, pn, kind; const char* a; const char* b; };

struct Sched {
    int nM, nN, nwg, G, c; const char* A; const char* B; size_t tstep;
    int nx, xnN; const char* XA; const char* XB;
    __device__ __forceinline__ void init(int M_, int N_, int K_, int G_, int c_, const void* A_, const void* B_) { nM = M_ / BM; nN = N_ / BM; nwg = nM * nN; G = G_; c = c_; A = (const char*)A_; B = (const char*)B_; tstep = (size_t)BM * K_ * 2; nx = 0; xnN = 1; XA = nullptr; XB = nullptr; }
    __device__ __forceinline__ bool next(int i, Unit& u) const {
        long L = (long)i * G + c;
        if (L < nwg) {
            int wgid = (int)L; { const int q = nwg / NXCD, r = nwg % NXCD, xcd = wgid % NXCD, off = wgid / NXCD; wgid = (xcd < r ? xcd * (q + 1) : r * (q + 1) + (xcd - r) * q) + off; }
            const int nig = WGM * nN, gid = wgid / nig, fm = gid * WGM, gsz = (nM - fm) < WGM ? (nM - fm) : WGM;
            u.pm = fm + ((wgid % nig) % gsz); u.pn = (wgid % nig) / gsz; u.kind = 0; u.a = A + (size_t)u.pm * tstep; u.b = B + (size_t)u.pn * tstep; return true;
        }
        L -= nwg; if (L >= nx) return false;
        u.pm = (int)L / xnN; u.pn = (int)L % xnN; u.kind = 1; u.a = XA + (size_t)u.pm * tstep; u.b = XB + (size_t)u.pn * tstep; return true;
    }
};

template <class Epi, bool ALIGN_EPI, bool SP2>
__device__ __forceinline__ void gemm_phase(LAS unsigned char* lds, const int K, const Sched& S, const Epi& E) {
    const int tid = threadIdx.x, wid = __builtin_amdgcn_readfirstlane(tid >> 6), lane = tid & 63, wr = wid >> 2, wc = wid & 3, fr = lane & 15, fq = lane >> 4;
    const int nt = K / BK;
    unsigned voffA[2], voffB[2];
#pragma unroll
    for (int i = 0; i < 2; ++i) { int R, C; stage_rc(tid * 16 + i * 8192, R, C); const int Rb = Epi::PERM ? ((R & ~31) + perm32(R & 31)) : R;
        voffA[i] = (unsigned)(R * K + C) * 2u; voffB[i] = (unsigned)(Rb * K + C) * 2u; }
    const size_t kstep = (size_t)(BK * 2);
    const size_t hstep = (size_t)HALF * K * 2;
    const unsigned ldsw = (unsigned)wid * 1024u;
    const int aoff = lds_byte(wr * 64 + fr, fq * 8), boff = lds_byte(wc * 32 + fr, fq * 8);
#define PG8_SA(b, h) (((b) * 2 + (h)) * HTB)
#define PG8_SB(b, h) ((4 + (b) * 2 + (h)) * HTB)
#define PG8_STAGE(bufoff, gbase, voff) do { _Pragma("unroll") for (int _i = 0; _i < 2; ++_i) \
        __builtin_amdgcn_global_load_lds((const unsigned*)((const char*)(gbase) + (voff)[_i]), (LAS unsigned*)(lds + (bufoff) + ldsw + _i * 8192), 16, 0, 0); } while (0)
#define PG8_LDA(dst, b, h) do { _Pragma("unroll") for (int m = 0; m < 4; ++m) _Pragma("unroll") for (int k = 0; k < 2; ++k) dst[m][k] = *(const LAS bf16x8*)(lds + PG8_SA(b, h) + aoff + m * 2048 + k * 1024); } while (0)
#define PG8_LDB(dst, b, h) do { _Pragma("unroll") for (int n = 0; n < 2; ++n) _Pragma("unroll") for (int k = 0; k < 2; ++k) dst[n][k] = *(const LAS bf16x8*)(lds + PG8_SB(b, h) + boff + n * 2048 + k * 1024); } while (0)
#define PG8_MMA(ai, bj, At, Bt) do { __builtin_amdgcn_s_setprio(1); _Pragma("unroll") for (int m = 0; m < 4; ++m) _Pragma("unroll") for (int n = 0; n < 2; ++n) _Pragma("unroll") for (int k = 0; k < 2; ++k) \
        acc[ai][bj][m][n] = __builtin_amdgcn_mfma_f32_16x16x32_bf16(Bt[n][k], At[m][k], acc[ai][bj][m][n], 0, 0, 0); __builtin_amdgcn_s_setprio(0); } while (0)
#define PG8_WAIT_V(n) asm volatile("s_waitcnt vmcnt(" #n ")" ::: "memory")
#define PG8_WAIT_L(n) asm volatile("s_waitcnt lgkmcnt(" #n ")" ::: "memory")
#define PG8_BAR __builtin_amdgcn_s_barrier()
#define PG8_SCHED __builtin_amdgcn_sched_barrier(0)
    Unit cur, nxt; int ui = 0;
    if (!S.next(0, cur)) return;
    f32x4 acc[2][2][4][2];
#pragma unroll
    for (int a = 0; a < 2; ++a)
#pragma unroll
        for (int b = 0; b < 2; ++b)
#pragma unroll
            for (int m = 0; m < 4; ++m)
#pragma unroll
                for (int n = 0; n < 2; ++n) acc[a][b][m][n] = (f32x4){0.f, 0.f, 0.f, 0.f};
    bf16x8 At[4][2], B0[2][2], B1[2][2];
    const char* cA = cur.a; const char* cB = cur.b;
    if constexpr (SP2) {
        PG8_STAGE(PG8_SB(0, 0), cB, voffB); PG8_STAGE(PG8_SB(0, 1), cB + hstep, voffB); PG8_STAGE(PG8_SA(0, 0), cA, voffA); PG8_STAGE(PG8_SA(0, 1), cA + hstep, voffA);
        if (wr == 1) PG8_BAR;
        PG8_WAIT_V(2); PG8_BAR;
        PG8_STAGE(PG8_SB(1, 0), cB + kstep, voffB); PG8_STAGE(PG8_SA(1, 0), cA + kstep, voffA); PG8_STAGE(PG8_SB(1, 1), cB + hstep + kstep, voffB);
        PG8_WAIT_V(6); PG8_BAR;
    } else {
        PG8_STAGE(PG8_SB(0, 0), cB, voffB); PG8_STAGE(PG8_SA(0, 0), cA, voffA); PG8_STAGE(PG8_SB(0, 1), cB + hstep, voffB); PG8_STAGE(PG8_SA(0, 1), cA + hstep, voffA);
        if (wr == 1) PG8_BAR;
        PG8_WAIT_V(4); PG8_BAR;
        PG8_STAGE(PG8_SB(1, 0), cB + kstep, voffB); PG8_STAGE(PG8_SA(1, 0), cA + kstep, voffA); PG8_STAGE(PG8_SB(1, 1), cB + hstep + kstep, voffB);
        PG8_WAIT_V(6); PG8_BAR;
    }
    for (;;) {
        const bool has_next = S.next(ui + 1, nxt);
        const char* nA = has_next ? nxt.a : cA; const char* nB = has_next ? nxt.b : cB;
        for (int t = 0; t < nt; t += 2) {
            const bool last = (t == nt - 2);
            const char* a1 = cA + (size_t)(t + 1) * kstep;
            const char* a2 = last ? nA : cA + (size_t)(t + 2) * kstep; const char* b2 = last ? nB : cB + (size_t)(t + 2) * kstep;
            const char* a3 = a2 + kstep; const char* b3 = b2 + kstep;
            if constexpr (SP2) {
            PG8_LDB(B0, 0, 0); PG8_LDB(B1, 0, 1); PG8_SCHED; PG8_LDA(At, 0, 0); PG8_STAGE(PG8_SA(1, 1), a1 + hstep, voffA);
            PG8_WAIT_V(8); PG8_WAIT_L(0); PG8_BAR; PG8_MMA(0, 0, At, B0); PG8_MMA(0, 1, At, B1); PG8_BAR; PG8_SCHED;
            PG8_LDA(At, 0, 1); PG8_STAGE(PG8_SB(0, 0), b2, voffB); PG8_STAGE(PG8_SB(0, 1), b2 + hstep, voffB); PG8_STAGE(PG8_SA(0, 0), a2, voffA);
            PG8_WAIT_V(8); PG8_WAIT_L(0); PG8_BAR; PG8_MMA(1, 0, At, B0); PG8_MMA(1, 1, At, B1); PG8_BAR; PG8_SCHED;
            PG8_LDB(B0, 1, 0); PG8_LDB(B1, 1, 1); PG8_SCHED; PG8_LDA(At, 1, 0); PG8_STAGE(PG8_SA(0, 1), a2 + hstep, voffA);
            PG8_WAIT_V(8); PG8_WAIT_L(0); PG8_BAR; PG8_MMA(0, 0, At, B0); PG8_MMA(0, 1, At, B1); PG8_BAR; PG8_SCHED;
            PG8_LDA(At, 1, 1); PG8_STAGE(PG8_SB(1, 0), b3, voffB); PG8_STAGE(PG8_SB(1, 1), b3 + hstep, voffB); PG8_STAGE(PG8_SA(1, 0), a3, voffA);
            PG8_WAIT_V(8); PG8_WAIT_L(0); PG8_BAR; PG8_MMA(1, 0, At, B0); PG8_MMA(1, 1, At, B1); PG8_BAR; PG8_SCHED;
            } else {
            PG8_LDB(B0, 0, 0); PG8_SCHED; PG8_LDA(At, 0, 0); PG8_STAGE(PG8_SA(1, 1), a1 + hstep, voffA);
            PG8_WAIT_L(8); PG8_BAR; PG8_WAIT_L(0); PG8_MMA(0, 0, At, B0); PG8_BAR; PG8_SCHED;
            PG8_LDB(B1, 0, 1); PG8_STAGE(PG8_SB(0, 0), b2, voffB);
            PG8_BAR; PG8_WAIT_L(0); PG8_MMA(0, 1, At, B1); PG8_BAR;
            PG8_LDA(At, 0, 1); PG8_STAGE(PG8_SA(0, 0), a2, voffA);
            PG8_BAR; PG8_WAIT_L(0); PG8_MMA(1, 0, At, B0); PG8_BAR; PG8_SCHED;
            PG8_STAGE(PG8_SB(0, 1), b2 + hstep, voffB);
            PG8_WAIT_V(6); PG8_BAR; PG8_MMA(1, 1, At, B1); PG8_BAR;
            PG8_LDB(B0, 1, 0); PG8_SCHED; PG8_LDA(At, 1, 0); PG8_STAGE(PG8_SA(0, 1), a2 + hstep, voffA);
            PG8_WAIT_L(8); PG8_BAR; PG8_WAIT_L(0); PG8_MMA(0, 0, At, B0); PG8_BAR; PG8_SCHED;
            PG8_LDB(B1, 1, 1); PG8_STAGE(PG8_SB(1, 0), b3, voffB);
            PG8_BAR; PG8_WAIT_L(0); PG8_MMA(0, 1, At, B1); PG8_BAR;
            PG8_LDA(At, 1, 1); PG8_STAGE(PG8_SA(1, 0), a3, voffA);
            PG8_BAR; PG8_WAIT_L(0); PG8_MMA(1, 0, At, B0); PG8_BAR; PG8_SCHED;
            PG8_STAGE(PG8_SB(1, 1), b3 + hstep, voffB);
            PG8_WAIT_V(6); PG8_BAR; PG8_MMA(1, 1, At, B1); PG8_BAR;
            }
        }
        if constexpr (ALIGN_EPI) { if (wr == 0) PG8_BAR; }
        E(acc, cur, wr, wc, fr, fq);
        if (!has_next) break;
#pragma unroll
        for (int a = 0; a < 2; ++a)
#pragma unroll
            for (int b = 0; b < 2; ++b)
#pragma unroll
                for (int m = 0; m < 4; ++m)
#pragma unroll
                    for (int n = 0; n < 2; ++n) acc[a][b][m][n] = (f32x4){0.f, 0.f, 0.f, 0.f};
        cur = nxt; cA = nA; cB = nB; ++ui;
        if constexpr (ALIGN_EPI) { if (wr == 1) PG8_BAR; }
    }
    PG8_WAIT_V(0);
    if constexpr (!ALIGN_EPI) { if (wr == 0) PG8_BAR; }
    PG8_BAR;
#undef PG8_SA
#undef PG8_SB
#undef PG8_STAGE
#undef PG8_LDA
#undef PG8_LDB
#undef PG8_MMA
#undef PG8_WAIT_V
#undef PG8_WAIT_L
#undef PG8_BAR
#undef PG8_SCHED
}

__device__ __forceinline__ float silu_mul(float g, float u) { return g * __builtin_amdgcn_rcpf(1.0f + __builtin_amdgcn_exp2f(-1.4426950408889634f * g)) * u; }

struct EpiSwiglu {
    static constexpr bool PERM = true;
    bf16_t* act; bf16_t* xo;
    __device__ __forceinline__ void operator()(const f32x4 (&acc)[2][2][4][2], const Unit& u, int wr, int wc, int fr, int fq) const {
        const int row0 = u.pm * BM + wr * 64 + fr;
        if (u.kind == 0) {
            const int col0 = u.pn * HALF + wc * 32 + 8 * fq;
#pragma unroll
            for (int ai = 0; ai < 2; ++ai)
#pragma unroll
                for (int m = 0; m < 4; ++m) {
                    const f32x4 g0 = acc[ai][0][m][0], g1 = acc[ai][0][m][1], u0 = acc[ai][1][m][0], u1 = acc[ai][1][m][1];
                    u32x4 w; w.x = pk2(silu_mul(g0[0], u0[0]), silu_mul(g0[1], u0[1])); w.y = pk2(silu_mul(g0[2], u0[2]), silu_mul(g0[3], u0[3]));
                    w.z = pk2(silu_mul(g1[0], u1[0]), silu_mul(g1[1], u1[1])); w.w = pk2(silu_mul(g1[2], u1[2]), silu_mul(g1[3], u1[3]));
                    *(u32x4*)(act + (size_t)(row0 + ai * HALF + m * 16) * FF + col0) = w; }
        } else {
            const int col0 = u.pn * BM + wc * 32 + 8 * fq;
#pragma unroll
            for (int ai = 0; ai < 2; ++ai)
#pragma unroll
                for (int m = 0; m < 4; ++m)
#pragma unroll
                    for (int bj = 0; bj < 2; ++bj) { const f32x4 v0 = acc[ai][bj][m][0], v1 = acc[ai][bj][m][1];
                        u32x4 w; w.x = pk2(v0[0], v0[1]); w.y = pk2(v0[2], v0[3]); w.z = pk2(v1[0], v1[1]); w.w = pk2(v1[2], v1[3]);
                        *(u32x4*)(xo + (size_t)(row0 + ai * HALF + m * 16) * 1024 + col0 + bj * HALF) = w; }
        }
    }
};
struct EpiBias {
    static constexpr bool PERM = true;
    bf16_t* O; int ldc; const float* bias;
    __device__ __forceinline__ void operator()(const f32x4 (&acc)[2][2][4][2], const Unit& u, int wr, int wc, int fr, int fq) const {
        const int row0 = u.pm * BM + wr * 64 + fr, col0 = u.pn * BM + wc * 32 + 8 * fq;
        f32x4 bv[2][2];
#pragma unroll
        for (int bj = 0; bj < 2; ++bj)
#pragma unroll
            for (int n = 0; n < 2; ++n) bv[bj][n] = *(const f32x4*)(bias + col0 + bj * HALF + 4 * n);
#pragma unroll
        for (int ai = 0; ai < 2; ++ai)
#pragma unroll
            for (int m = 0; m < 4; ++m)
#pragma unroll
                for (int bj = 0; bj < 2; ++bj) { const f32x4 v0 = acc[ai][bj][m][0] + bv[bj][0], v1 = acc[ai][bj][m][1] + bv[bj][1];
                    u32x4 w; w.x = pk2(v0[0], v0[1]); w.y = pk2(v0[2], v0[3]); w.z = pk2(v1[0], v1[1]); w.w = pk2(v1[2], v1[3]);
                    *(u32x4*)(O + (size_t)(row0 + ai * HALF + m * 16) * ldc + col0 + bj * HALF) = w; }
    }
};
struct EpiRes {
    static constexpr bool PERM = false;
    const float* res; float* out; float rs, s;
    __device__ __forceinline__ void operator()(const f32x4 (&acc)[2][2][4][2], const Unit& u, int wr, int wc, int fr, int fq) const {
        const int row0 = u.pm * BM + wr * 64 + fr, col0 = u.pn * BM + wc * 32 + 4 * fq;
#pragma unroll
        for (int ai = 0; ai < 2; ++ai)
#pragma unroll
            for (int m = 0; m < 4; ++m) { const size_t off = (size_t)(row0 + ai * HALF + m * 16) * D + col0;
                f32x4 r[2][2];
#pragma unroll
                for (int bj = 0; bj < 2; ++bj)
#pragma unroll
                    for (int n = 0; n < 2; ++n) r[bj][n] = *(const f32x4*)(res + off + bj * HALF + n * 16);
#pragma unroll
                for (int bj = 0; bj < 2; ++bj)
#pragma unroll
                    for (int n = 0; n < 2; ++n) *(f32x4*)(out + off + bj * HALF + n * 16) = r[bj][n] * rs + acc[ai][bj][m][n] * s;
                if (m & 1) asm volatile("" ::: "memory"); }
    }
};
}

#define XB_TMO      128
#define XB_XCNT(j)  (256  + 64 * (j))
#define XB_XSUB(j)  (1280 + 64 * (j))
#define XB_XGEN(j)  (2304 + 64 * (j))
#define XB_TOP      3328
#define XB_TOPGEN   3392
#define XCD_BAR_WORDS 3456
#define XB_SPIN_CAP (1u << 18)
__device__ __forceinline__ unsigned xb_ld(unsigned* p)              { return __hip_atomic_load(p, __ATOMIC_RELAXED, __HIP_MEMORY_SCOPE_AGENT); }
__device__ __forceinline__ unsigned xb_add(unsigned* p, unsigned v) { return __hip_atomic_fetch_add(p, v, __ATOMIC_RELAXED, __HIP_MEMORY_SCOPE_AGENT); }
__device__ __forceinline__ unsigned xb_xcc_id() { return (unsigned)__builtin_amdgcn_s_getreg((3 << 11) | 20) & 0xFu; }
#define XB_SPIN(cond, bar) do { unsigned _sp = 0; while (cond) { __builtin_amdgcn_s_sleep(1); \
    if ((++_sp & 255u) == 0u) { if (xb_ld(&(bar)[XB_TMO])) break; if (_sp > XB_SPIN_CAP) { atomicAdd(&(bar)[XB_TMO], 1u); break; } } } } while (0)
struct XcdBarrier { unsigned* bar; unsigned x; volatile LAS unsigned* st; };
__device__ __forceinline__ XcdBarrier xcd_barrier_post(unsigned* bar, volatile LAS unsigned* st) {
    XcdBarrier b; b.bar = bar; b.x = xb_xcc_id(); b.st = st;
    if (threadIdx.x == 0) (void)xb_add(&bar[XB_XCNT(b.x)], 1u);
    return b;
}
__device__ __forceinline__ void xcd_barrier_complete(unsigned* bar, unsigned x, unsigned& nloc, unsigned& nx) {
    const unsigned G = gridDim.x * gridDim.y * gridDim.z;
    unsigned sum, cnt, mine, sp = 0u;
    for (;;) {
        sum = 0u; cnt = 0u; mine = 0u;
#pragma unroll
        for (unsigned j = 0; j < 16; ++j) { const unsigned c = xb_ld(&bar[XB_XCNT(j)]); sum += c; cnt += (c > 0u) ? 1u : 0u; mine = (j == x) ? c : mine; }
        if (sum == G) break;
        __builtin_amdgcn_s_sleep(1);
        if ((++sp & 255u) == 0u) { if (xb_ld(&bar[XB_TMO])) break; if (sp > XB_SPIN_CAP) { atomicAdd(&bar[XB_TMO], 1u); break; } }
    }
    nloc = mine > 0u ? mine : 1u; nx = cnt > 0u ? cnt : 1u;
}
__device__ __forceinline__ void xcd_barrier(const XcdBarrier& b) {
    asm volatile("s_waitcnt vmcnt(0)" ::: "memory");
    __syncthreads();
    if (threadIdx.x == 0) {
        unsigned* bar = b.bar;
        __builtin_amdgcn_s_waitcnt(0);
        unsigned nloc = b.st[0], nx = b.st[1];
        if (nloc == 0u) { xcd_barrier_complete(bar, b.x, nloc, nx); b.st[0] = nloc; b.st[1] = nx; }
        const unsigned old = xb_add(&bar[XB_XSUB(b.x)], 1u);
        const unsigned gen = old / nloc;
        if (old + 1u == (gen + 1u) * nloc) {
            __builtin_amdgcn_fence(__ATOMIC_RELEASE, "agent");
            asm volatile("s_waitcnt vmcnt(0)" ::: "memory");
            const unsigned og = xb_add(&bar[XB_TOP], 1u);
            const unsigned tg = og / nx;
            if (og + 1u == (tg + 1u) * nx) xb_add(&bar[XB_TOPGEN], 1u);
            else XB_SPIN(xb_ld(&bar[XB_TOPGEN]) == tg, bar);
            __builtin_amdgcn_fence(__ATOMIC_ACQUIRE, "agent");
            xb_add(&bar[XB_XGEN(b.x)], 1u);
            asm volatile("s_waitcnt vmcnt(0)" ::: "memory");
        } else {
            XB_SPIN(xb_ld(&bar[XB_XGEN(b.x)]) == gen, bar);
            __builtin_amdgcn_fence(__ATOMIC_ACQUIRE, "agent");
            asm volatile("s_waitcnt vmcnt(0)" ::: "memory");
        }
    }
    __syncthreads();
}

struct Args {
    const float* x; const float* mem; const float* ln1_g; const float* ln1_b; const float* w1g; const float* w1u; const float* w1d; const float* w_in; const float* b_in;
    const float* conv_w; const float* sinks; const float* w_mem; const float* w_out; const float* ln2_g; const float* ln2_b; const float* w2g; const float* w2u; const float* w2d;
    const float* ln3_g; const float* ln3_b; const float* rel_bias; float* out; unsigned char* ws; int ph_lo, ph_hi;
};

#define LDS_WAIT() asm volatile("s_waitcnt lgkmcnt(0)" ::: "memory")
template <int MODE>
__device__ __forceinline__ void p0_transpose_item(const float* W, int K, int N, bf16_t* WT, LAS float* scr, int item, int lane) {
    const int nblk = N / 32, kb = item / nblk, nb = item % nblk, k0 = 64 * kb, n0 = 32 * nb;
#pragma unroll 8
    for (int i = 0; i < 32; ++i) { const int kk = 2 * i + (lane >> 5); scr[kk * 33 + (lane & 31)] = W[(size_t)(k0 + kk) * N + n0 + (lane & 31)]; }
    LDS_WAIT(); asm volatile("" ::: "memory");
    const int c = lane & 7;
    const int r0 = (MODE == 0) ? n0 : ((n0 >> 7) * 256 + (n0 & 127) + (MODE == 2 ? 128 : 0));
#pragma unroll
    for (int j = 0; j < 4; ++j) { const int n = (lane >> 3) + 8 * j; const LAS float* s = scr + (8 * c) * 33 + n;
        u32x4 o; o.x = pk2(s[0 * 33], s[1 * 33]); o.y = pk2(s[2 * 33], s[3 * 33]); o.z = pk2(s[4 * 33], s[5 * 33]); o.w = pk2(s[6 * 33], s[7 * 33]);
        *(GAS u32x4*)(WT + (size_t)(r0 + n) * K + k0 + 8 * c) = o; }
    LDS_WAIT(); asm volatile("" ::: "memory");
}
__device__ __forceinline__ float wave_sum(float v) {
#pragma unroll
    for (int o = 1; o < 64; o <<= 1) v += __shfl_xor(v, o);
    return v;
}
__device__ __forceinline__ void cvt_rows(const float* src, bf16_t* dst, size_t n, int gw, int NGW, int lane) {
    const size_t nit = n / 512;
    for (size_t it = gw; it < nit; it += NGW) {
        const f32x4 a = *(const GAS f32x4*)(src + it * 512 + lane * 8), b = *(const GAS f32x4*)(src + it * 512 + lane * 8 + 4);
        u32x4 o; o.x = pk2(a[0], a[1]); o.y = pk2(a[2], a[3]); o.z = pk2(b[0], b[1]); o.w = pk2(b[2], b[3]);
        *(GAS u32x4*)(dst + it * 512 + lane * 8) = o;
    }
}
__device__ __forceinline__ void ln_phase(const float* X, float* Yf, bf16_t* Yb, const float* g, const float* b, int gw, int NGW, int lane) {
    for (int m = gw; m < M; m += NGW) {
        const GAS f32x4* xr = (const GAS f32x4*)(X + (size_t)m * D) + lane;
        f32x4 v[8]; float s = 0.f;
#pragma unroll
        for (int j = 0; j < 8; ++j) { v[j] = xr[64 * j]; s += (v[j][0] + v[j][1]) + (v[j][2] + v[j][3]); }
        const float mean = wave_sum(s) * (1.f / D); float s2 = 0.f;
#pragma unroll
        for (int j = 0; j < 8; ++j) { v[j] = v[j] - mean; s2 += (v[j][0] * v[j][0] + v[j][1] * v[j][1]) + (v[j][2] * v[j][2] + v[j][3] * v[j][3]); }
        const float rstd = 1.f / sqrtf(wave_sum(s2) * (1.f / D) + LN_EPS);
#pragma unroll
        for (int j = 0; j < 8; ++j) {
            const f32x4 gg = *((const GAS f32x4*)g + lane + 64 * j), bb = *((const GAS f32x4*)b + lane + 64 * j);
            const f32x4 y = v[j] * rstd * gg + bb;
            if (Yf) *((GAS f32x4*)(Yf + (size_t)m * D) + lane + 64 * j) = y;
            if (Yb) { u32x2 w; w.x = pk2(y[0], y[1]); w.y = pk2(y[2], y[3]); *((GAS u32x2*)(Yb + (size_t)m * D) + lane + 64 * j) = w; }
        }
    }
}

__device__ __forceinline__ f32x4 mfma16(bf16x8 a, bf16x8 b, f32x4 c) { return __builtin_amdgcn_mfma_f32_16x16x32_bf16(a, b, c, 0, 0, 0); }

__device__ __forceinline__ void conv_unit(const bf16_t* proj, const float* cw, bf16_t* mix, int u, int tid) {
#pragma unroll 1
    for (int i = 0; i < 6; ++i) {
        const int id = tid + 512 * i, tl = id / 96, cg = id % 96, m = 32 * u + tl, t = m % SEQ, ch = 8 * cg;
        const bf16_t* p = proj + (size_t)m * PROJ;
        const u32x4 bg = *(const u32x4*)(p + OFF_B + ch);
        float y[8];
#pragma unroll
        for (int e = 0; e < 8; ++e) y[e] = 0.f;
#pragma unroll
        for (int j = 0; j < 3; ++j) {
            const int back = 2 - j;
            if (t >= back) {
                const bf16_t* pj = p - (size_t)back * PROJ;
                const u32x4 cc = *(const u32x4*)(pj + OFF_C + ch), uu = *(const u32x4*)(pj + OFF_U + ch);
                const f32x4 w0 = *(const f32x4*)(cw + j * CONV + ch), w1 = *(const f32x4*)(cw + j * CONV + ch + 4);
#pragma unroll
                for (int e = 0; e < 8; ++e) {
                    const unsigned cw32 = cc[e >> 1], uw32 = uu[e >> 1];
                    const float cf = __uint_as_float((e & 1) ? (cw32 & 0xffff0000u) : (cw32 << 16)), uf = __uint_as_float((e & 1) ? (uw32 & 0xffff0000u) : (uw32 << 16));
                    const float w = (e < 4) ? w0[e & 3] : w1[e & 3];
                    y[e] = fmaf(w, cf * uf, y[e]);
                }
            }
        }
        u32x4 o;
#pragma unroll
        for (int e2 = 0; e2 < 4; ++e2) {
            const unsigned b32 = bg[e2];
            o[e2] = pk2(__uint_as_float(b32 << 16) * y[2 * e2], __uint_as_float(b32 & 0xffff0000u) * y[2 * e2 + 1]);
        }
        *(u32x4*)(mix + (size_t)m * MIX + ch) = o;
    }
}

__device__ __forceinline__ void swa_unit(const bf16_t* proj, const float* rel_bias, const float* sinks, bf16_t* mix, LAS unsigned char* lds, int u, int tid, int wid, int lane) {
    const int b = u >> 6, kvh = (u >> 4) & 3, nb = u & 15;
    LAS unsigned char* Ks = lds;
    LAS unsigned char* Vt = lds + 39168;
    LAS float* lut = (LAS float*)(lds + 39168 + 35840);
    const long rowmin = (long)b * SEQ, rowb = rowmin + 128 * nb - 128;
#pragma unroll
    for (int i = 0; i < 4; ++i) {
        const int id = tid + 512 * i, key = id >> 3, c = id & 7; long r = rowb + key; r = r < rowmin ? rowmin : r;
        const u32x4 v = *(const u32x4*)(proj + (size_t)r * PROJ + OFF_K + kvh * 64 + c * 8);
        *(LAS u32x4*)(Ks + key * 144 + c * 16) = v;
    }
    if (tid < 144) *(LAS u32x4*)(Ks + 256 * 144 + tid * 16) = (u32x4){0u, 0u, 0u, 0u};
#pragma unroll
    for (int i = 0; i < 2; ++i) {
        const int id = tid + 512 * i, pr = id & 127, c = id >> 7; long r0 = rowb + 2 * pr, r1 = r0 + 1; r0 = r0 < rowmin ? rowmin : r0; r1 = r1 < rowmin ? rowmin : r1;
        const u32x4 va = *(const u32x4*)(proj + (size_t)r0 * PROJ + OFF_V + kvh * 64 + c * 8), vb = *(const u32x4*)(proj + (size_t)r1 * PROJ + OFF_V + kvh * 64 + c * 8);
#pragma unroll
        for (int e = 0; e < 8; ++e) {
            const unsigned lo = (e & 1) ? (va[e >> 1] >> 16) : (va[e >> 1] & 0xffffu), hi = (e & 1) ? (vb[e >> 1] & 0xffff0000u) : (vb[e >> 1] << 16);
            *(LAS unsigned*)(Vt + (c * 8 + e) * 560 + pr * 4) = lo | hi;
        }
    }
    if (tid < 128) *(LAS u32x4*)(Vt + (tid >> 1) * 560 + 512 + (tid & 1) * 16) = (u32x4){0u, 0u, 0u, 0u};
    if (tid < 384) { const int g = tid >> 7, dist = tid & 127; lut[tid] = rel_bias[T5B[dist] * NH + kvh * 3 + g]; }
    __syncthreads();
    const int fr = lane & 15, fq = lane >> 4, qi = 16 * wid + fr;
    const size_t mrow = (size_t)b * SEQ + 128 * nb + qi;
#pragma unroll 1
    for (int g = 0; g < 3; ++g) {
        const int h = kvh * 3 + g;
        bf16x8 qf[2];
#pragma unroll
        for (int ks = 0; ks < 2; ++ks) qf[ks] = *(const bf16x8*)(proj + mrow * PROJ + OFF_Q + h * 64 + ks * 32 + 8 * fq);
        f32x4 s[10];
#pragma unroll
        for (int tt = 0; tt < 10; ++tt) {
            f32x4 a = {0.f, 0.f, 0.f, 0.f};
#pragma unroll
            for (int ks = 0; ks < 2; ++ks) { const bf16x8 kf = *(const LAS bf16x8*)(Ks + (16 * (wid + tt) + fr) * 144 + ks * 64 + fq * 16); a = mfma16(kf, qf[ks], a); }
            s[tt] = a;
        }
        const float sink = sinks[h];
        float mx = -1e30f;
#pragma unroll
        for (int tt = 0; tt < 10; ++tt)
#pragma unroll
            for (int r = 0; r < 4; ++r) {
                const int kj = 16 * (wid + tt) + 4 * fq + r, dist = 128 + qi - kj;
                const bool valid = (dist >= 0) && (dist < 128) && (nb > 0 || kj >= 128);
                const int dl = dist < 0 ? 0 : (dist > 127 ? 127 : dist);
                const float lg = valid ? (s[tt][r] * 0.125f + lut[g * 128 + dl]) : -1e30f;
                s[tt][r] = lg; mx = fmaxf(mx, lg);
            }
        mx = fmaxf(mx, __shfl_xor(mx, 16)); mx = fmaxf(mx, __shfl_xor(mx, 32));
        const float mf = fmaxf(mx, sink);
        float sum = 0.f;
#pragma unroll
        for (int tt = 0; tt < 10; ++tt)
#pragma unroll
            for (int r = 0; r < 4; ++r) { const float p = __expf(s[tt][r] - mf); s[tt][r] = p; sum += p; }
        sum += __shfl_xor(sum, 16); sum += __shfl_xor(sum, 32);
        const float inv = 1.0f / (sum + __expf(sink - mf));
        bf16x8 pf[5];
#pragma unroll
        for (int kk = 0; kk < 5; ++kk) { u32x4 w; w.x = pk2(s[2 * kk][0], s[2 * kk][1]); w.y = pk2(s[2 * kk][2], s[2 * kk][3]); w.z = pk2(s[2 * kk + 1][0], s[2 * kk + 1][1]); w.w = pk2(s[2 * kk + 1][2], s[2 * kk + 1][3]);
            pf[kk] = __builtin_bit_cast(bf16x8, w); }
#pragma unroll
        for (int c = 0; c < 4; ++c) {
            f32x4 o = {0.f, 0.f, 0.f, 0.f};
#pragma unroll
            for (int kk = 0; kk < 5; ++kk) {
                const LAS unsigned char* vp = Vt + (16 * c + fr) * 560 + (16 * (wid + 2 * kk) + 4 * fq) * 2;
                const s16x4 lo = *(const LAS s16x4*)vp, hi = *(const LAS s16x4*)(vp + 32);
                const bf16x8 vf = {lo[0], lo[1], lo[2], lo[3], hi[0], hi[1], hi[2], hi[3]};
                o = mfma16(vf, pf[kk], o);
            }
            u32x2 w; w.x = pk2(o[0] * inv, o[1] * inv); w.y = pk2(o[2] * inv, o[3] * inv);
            *(u32x2*)(mix + mrow * MIX + CONV + h * 64 + 16 * c + 4 * fq) = w;
        }
    }
}

__device__ __forceinline__ void mem_unit(const bf16_t* proj, const bf16_t* memkv, bf16_t* mix, LAS unsigned char* lds, int u, int tid, int wid, int lane) {
    const int b = u >> 6, h = (u >> 4) & 3, qb = u & 15;
    LAS unsigned char* Ks = lds;
    LAS unsigned char* Vt = lds + 69632;
#pragma unroll
    for (int i = 0; i < 8; ++i) {
        const int id = tid + 512 * i, key = id >> 4, c = id & 15;
        const u32x4 v = *(const u32x4*)(memkv + (size_t)(b * MEM_LEN + key) * 1024 + h * 128 + c * 8);
        *(LAS u32x4*)(Ks + key * 272 + c * 16) = v;
    }
#pragma unroll
    for (int i = 0; i < 4; ++i) {
        const int id = tid + 512 * i, pr = id & 127, c = id >> 7;
        const bf16_t* src = memkv + (size_t)(b * MEM_LEN + 2 * pr) * 1024 + MEMD + h * 128 + c * 8;
        const u32x4 va = *(const u32x4*)src, vb = *(const u32x4*)(src + 1024);
#pragma unroll
        for (int e = 0; e < 8; ++e) {
            const unsigned lo = (e & 1) ? (va[e >> 1] >> 16) : (va[e >> 1] & 0xffffu), hi = (e & 1) ? (vb[e >> 1] & 0xffff0000u) : (vb[e >> 1] << 16);
            *(LAS unsigned*)(Vt + (c * 8 + e) * 528 + pr * 4) = lo | hi;
        }
    }
    __syncthreads();
    const int fr = lane & 15, fq = lane >> 4, qi = 16 * wid + fr;
    const size_t mrow = (size_t)b * SEQ + 128 * qb + qi;
    bf16x8 qf[4];
#pragma unroll
    for (int ks = 0; ks < 4; ++ks) qf[ks] = *(const bf16x8*)(proj + mrow * PROJ + OFF_QM + h * 128 + ks * 32 + 8 * fq);
    f32x4 s[16];
    float mx = -1e30f;
#pragma unroll
    for (int t = 0; t < 16; ++t) {
        f32x4 a = {0.f, 0.f, 0.f, 0.f};
#pragma unroll
        for (int ks = 0; ks < 4; ++ks) { const bf16x8 kf = *(const LAS bf16x8*)(Ks + (16 * t + fr) * 272 + ks * 64 + fq * 16); a = mfma16(kf, qf[ks], a); }
        a = a * 0.08838834764831845f;
        s[t] = a; mx = fmaxf(mx, fmaxf(fmaxf(a[0], a[1]), fmaxf(a[2], a[3])));
    }
    mx = fmaxf(mx, __shfl_xor(mx, 16)); mx = fmaxf(mx, __shfl_xor(mx, 32));
    float sum = 0.f;
#pragma unroll
    for (int t = 0; t < 16; ++t)
#pragma unroll
        for (int r = 0; r < 4; ++r) { const float p = __expf(s[t][r] - mx); s[t][r] = p; sum += p; }
    sum += __shfl_xor(sum, 16); sum += __shfl_xor(sum, 32);
    const float inv = 1.0f / sum;
    bf16x8 pf[8];
#pragma unroll
    for (int kk = 0; kk < 8; ++kk) { u32x4 w; w.x = pk2(s[2 * kk][0], s[2 * kk][1]); w.y = pk2(s[2 * kk][2], s[2 * kk][3]); w.z = pk2(s[2 * kk + 1][0], s[2 * kk + 1][1]); w.w = pk2(s[2 * kk + 1][2], s[2 * kk + 1][3]);
        pf[kk] = __builtin_bit_cast(bf16x8, w); }
#pragma unroll
    for (int c = 0; c < 8; ++c) {
        f32x4 o = {0.f, 0.f, 0.f, 0.f};
#pragma unroll
        for (int kk = 0; kk < 8; ++kk) {
            const LAS unsigned char* vp = Vt + (16 * c + fr) * 528 + (32 * kk + 4 * fq) * 2;
            const s16x4 lo = *(const LAS s16x4*)vp, hi = *(const LAS s16x4*)(vp + 32);
            const bf16x8 vf = {lo[0], lo[1], lo[2], lo[3], hi[0], hi[1], hi[2], hi[3]};
            o = mfma16(vf, pf[kk], o);
        }
        u32x2 w; w.x = pk2(o[0] * inv, o[1] * inv); w.y = pk2(o[2] * inv, o[3] * inv);
        *(u32x2*)(mix + mrow * MIX + CONV + SWAD + h * 128 + 16 * c + 4 * fq) = w;
    }
}

__global__ void __launch_bounds__(NTHREADS, 2) fwd_megakernel(Args a) {
    extern __shared__ __attribute__((aligned(16))) unsigned char lds_raw[];
    LAS unsigned char* lds = (LAS unsigned char*)lds_raw;
    volatile LAS unsigned* MISC = (volatile LAS unsigned*)(lds + MISC_OFF);
    const int tid = threadIdx.x, lane = tid & 63, wave = __builtin_amdgcn_readfirstlane(tid >> 6);
    const int G = gridDim.x, bx = blockIdx.x, vcu = (G % 8 == 0) ? (bx % 8) * (G / 8) + bx / 8 : bx;
    const int gw = vcu * NWAVES + wave, NGW = G * NWAVES;
    unsigned char* ws = a.ws;
    bf16_t* W1GU = (bf16_t*)(ws + WS_W1GU); bf16_t* W1D = (bf16_t*)(ws + WS_W1D); bf16_t* WIN = (bf16_t*)(ws + WS_WIN); bf16_t* WMEM = (bf16_t*)(ws + WS_WMEM);
    bf16_t* WOUT = (bf16_t*)(ws + WS_WOUT); bf16_t* W2GU = (bf16_t*)(ws + WS_W2GU); bf16_t* W2D = (bf16_t*)(ws + WS_W2D);
    bf16_t* MEMB = (bf16_t*)(ws + WS_MEMB); bf16_t* MEMKV = (bf16_t*)(ws + WS_MEMKV); bf16_t* AB = (bf16_t*)(ws + WS_AB);
    bf16_t* ACT = (bf16_t*)(ws + WS_R1); bf16_t* PROJB = (bf16_t*)(ws + WS_R1); bf16_t* MIXB = (bf16_t*)(ws + WS_MIXB); float* BUFA = (float*)(ws + WS_BUFA);
    if (tid < 32) MISC[tid] = 0u;
    __syncthreads();
    XcdBarrier bar; bar.bar = (unsigned*)(ws + WS_CTL) + CW_BAR; bar.x = 0; bar.st = nullptr;
    if (!MK_PER_PHASE) bar = xcd_barrier_post((unsigned*)(ws + WS_CTL) + CW_BAR, MISC + 8);
    const int lo = a.ph_lo, hi = a.ph_hi;
#define IN(k) (lo <= (k) && (k) < hi)
#define GRID_BAR(k) do { if (IN(k) && IN((k) + 1)) xcd_barrier(bar); } while (0)

    if (IN(0)) {
        LAS float* scr = (LAS float*)(lds + wave * 16384);
        constexpr int I_GU = (D / 64) * (FF / 32), I_DN = (FF / 64) * (D / 32), I_IN = (D / 64) * (PROJ / 32), I_MEM = (D / 64) * (1024 / 32), I_OUT = (D / 64) * (D / 32);
        constexpr int NITEMS = 6 * I_GU + I_IN + I_MEM + I_OUT;
        static_assert(I_GU == I_DN, "items");
        for (int it = gw; it < NITEMS; it += NGW) {
            int r = it;
            if (r < I_GU) { p0_transpose_item<1>(a.w1g, D, FF, W1GU, scr, r, lane); continue; } r -= I_GU;
            if (r < I_GU) { p0_transpose_item<2>(a.w1u, D, FF, W1GU, scr, r, lane); continue; } r -= I_GU;
            if (r < I_DN) { p0_transpose_item<0>(a.w1d, FF, D, W1D, scr, r, lane); continue; } r -= I_DN;
            if (r < I_IN) { p0_transpose_item<0>(a.w_in, D, PROJ, WIN, scr, r, lane); continue; } r -= I_IN;
            if (r < I_MEM) { p0_transpose_item<0>(a.w_mem, D, 1024, WMEM, scr, r, lane); continue; } r -= I_MEM;
            if (r < I_OUT) { p0_transpose_item<0>(a.w_out, D, D, WOUT, scr, r, lane); continue; } r -= I_OUT;
            if (r < I_GU) { p0_transpose_item<1>(a.w2g, D, FF, W2GU, scr, r, lane); continue; } r -= I_GU;
            if (r < I_GU) { p0_transpose_item<2>(a.w2u, D, FF, W2GU, scr, r, lane); continue; } r -= I_GU;
            p0_transpose_item<0>(a.w2d, FF, D, W2D, scr, r, lane);
        }
        cvt_rows(a.x, AB, (size_t)M * D, gw, NGW, lane);
        cvt_rows(a.mem, MEMB, (size_t)MEMROWS * D, gw, NGW, lane);
    }
    GRID_BAR(0);
    if (IN(1)) {
        pg8::Sched S; S.init(M, GU, D, G, bx, AB, W1GU); S.nx = 16; S.xnN = 4; S.XA = (const char*)MEMB; S.XB = (const char*)WMEM;
        pg8::EpiSwiglu E{ACT, MEMKV};
        pg8::gemm_phase<pg8::EpiSwiglu, true, true>(lds, D, S, E);
    }
    GRID_BAR(1);
    if (IN(2)) {
        pg8::Sched S; S.init(M, D, FF, G, bx, ACT, W1D);
        pg8::EpiRes E{a.x, BUFA, ALPHA, 0.5f};
        pg8::gemm_phase<pg8::EpiRes, false, true>(lds, FF, S, E);
    }
    GRID_BAR(2);
    if (IN(3)) ln_phase(BUFA, BUFA, AB, a.ln1_g, a.ln1_b, gw, NGW, lane);
    GRID_BAR(3);
    if (IN(4)) {
        pg8::Sched S; S.init(M, PROJ, D, G, bx, AB, WIN);
        pg8::EpiBias E{PROJB, PROJ, a.b_in};
        pg8::gemm_phase<pg8::EpiBias, true, true>(lds, D, S, E);
    }
    GRID_BAR(4);
    if (IN(5)) {
        const int u = vcu;
        conv_unit(PROJB, a.conv_w, MIXB, u, tid);
        swa_unit(PROJB, a.rel_bias, a.sinks, MIXB, lds, u, tid, wave, lane);
        __syncthreads();
        mem_unit(PROJB, MEMKV, MIXB, lds, u, tid, wave, lane);
        __syncthreads();
    }
    GRID_BAR(5);
    if (IN(6)) {
        pg8::Sched S; S.init(M, D, MIX, G, bx, MIXB, WOUT);
        pg8::EpiRes E{BUFA, a.out, ALPHA, 1.0f};
        pg8::gemm_phase<pg8::EpiRes, false, true>(lds, MIX, S, E);
    }
    GRID_BAR(6);
    if (IN(7)) ln_phase(a.out, a.out, AB, a.ln2_g, a.ln2_b, gw, NGW, lane);
    GRID_BAR(7);
    if (IN(8)) {
        pg8::Sched S; S.init(M, GU, D, G, bx, AB, W2GU);
        pg8::EpiSwiglu E{ACT, MEMKV};
        pg8::gemm_phase<pg8::EpiSwiglu, true, true>(lds, D, S, E);
    }
    GRID_BAR(8);
    if (IN(9)) {
        pg8::Sched S; S.init(M, D, FF, G, bx, ACT, W2D);
        pg8::EpiRes E{a.out, BUFA, ALPHA, 0.5f};
        pg8::gemm_phase<pg8::EpiRes, false, true>(lds, FF, S, E);
    }
    GRID_BAR(9);
    if (IN(10)) ln_phase(BUFA, a.out, nullptr, a.ln3_g, a.ln3_b, gw, NGW, lane);
#undef IN
#undef GRID_BAR
}

extern "C" void kernel_launch(void* const* d_in, const int* in_sizes, int n_in, void* d_out, int out_size, void* d_ws, size_t ws_size, hipStream_t stream) {
    static int grid = 0;
    if (grid == 0) {
        if (n_in != 21 || in_sizes[0] != M * D || out_size != M * D || ws_size < WS_END) { fprintf(stderr, "kernel_launch: unexpected shapes (n_in %d, in0 %d, out %d, ws %zu); nothing launched\n", n_in, n_in > 0 ? in_sizes[0] : -1, out_size, ws_size); grid = -1; return; }
        int dev = 0, cus = 0;
        if (hipGetDevice(&dev) != hipSuccess || hipDeviceGetAttribute(&cus, hipDeviceAttributeMultiprocessorCount, dev) != hipSuccess) { grid = -1; return; }
        if (hipFuncSetAttribute((const void*)fwd_megakernel, hipFuncAttributeMaxDynamicSharedMemorySize, LDS_BYTES) != hipSuccess) { fprintf(stderr, "kernel_launch: hipFuncSetAttribute failed\n"); grid = -1; return; }
        int per_cu = 0;
        if (hipOccupancyMaxActiveBlocksPerMultiprocessor(&per_cu, (const void*)fwd_megakernel, NTHREADS, LDS_BYTES) != hipSuccess || per_cu < 1) fprintf(stderr, "kernel_launch: occupancy query reports %d\n", per_cu);
        (void)hipGetLastError();
        grid = cus;
        if (grid != 256) { fprintf(stderr, "kernel_launch: built for a 256-CU device, found %d CUs; nothing launched\n", cus); grid = -1; return; }
    }
    if (grid < 0) return;
    (void)hipMemsetAsync((char*)d_ws + WS_CTL, 0, CTL_ZERO_BYTES, stream);
    Args a{};
    a.x = (const float*)d_in[0]; a.mem = (const float*)d_in[1]; a.ln1_g = (const float*)d_in[2]; a.ln1_b = (const float*)d_in[3];
    a.w1g = (const float*)d_in[4]; a.w1u = (const float*)d_in[5]; a.w1d = (const float*)d_in[6]; a.w_in = (const float*)d_in[7]; a.b_in = (const float*)d_in[8];
    a.conv_w = (const float*)d_in[9]; a.sinks = (const float*)d_in[10]; a.w_mem = (const float*)d_in[11]; a.w_out = (const float*)d_in[12];
    a.ln2_g = (const float*)d_in[13]; a.ln2_b = (const float*)d_in[14]; a.w2g = (const float*)d_in[15]; a.w2u = (const float*)d_in[16]; a.w2d = (const float*)d_in[17];
    a.ln3_g = (const float*)d_in[18]; a.ln3_b = (const float*)d_in[19]; a.rel_bias = (const float*)d_in[20];
    a.out = (float*)d_out; a.ws = (unsigned char*)d_ws;
#if MK_PER_PHASE
    for (int p = 0; p < 11; ++p) { a.ph_lo = p; a.ph_hi = p + 1; hipLaunchKernelGGL(fwd_megakernel, dim3(grid), dim3(NTHREADS), LDS_BYTES, stream, a); }
#else
    a.ph_lo = 0; a.ph_hi = 11;
    hipLaunchKernelGGL(fwd_megakernel, dim3(grid), dim3(NTHREADS), LDS_BYTES, stream, a);
#endif
}
```
